# Optimizing an MI355X kernel written in HIP

```python
import jax, jax.numpy as jnp
from jax import lax
import numpy as np

D_MODEL = 1024
BATCH = 8
SEQ = 2048
DEPTH = 4
DEC_BATCH = 128
DEC_SEQ = 4
PAST_LEN = 16384
PAGE_SIZE = 128

N_MIXERS = 2
N_CONV = (DEPTH + 1) // 2
N_POOL = DEPTH // 2
CONV_W = 3
POOL_WINDOWS = (2, 4, 8, 16)
N_POOL_GROUPS = len(POOL_WINDOWS)
POOL_GROUP = D_MODEL // N_POOL_GROUPS
POOL_HIST = max(POOL_WINDOWS) - 1
D_FF = 2816
N_NORMS = 6
EPS = 1e-6

kernel_name = "macaron_conv_pool_hybrid_step"


def rmsnorm(x, g):
    xf = x.astype(jnp.float32)
    y = xf * lax.rsqrt(jnp.mean(xf * xf, axis=-1, keepdims=True) + EPS)
    return (y * g.astype(jnp.float32)).astype(x.dtype)


def swiglu(h, w_gate, w_up, w_down):
    a = jnp.einsum('bsd,df->bsf', h, w_gate)
    b = jnp.einsum('bsd,df->bsf', h, w_up)
    return jnp.einsum('bsf,fd->bsd', jax.nn.silu(a) * b, w_down)


def conv_mixer(u, hist, w_in, kernel, w_out):
    s = u.shape[1]
    bcv = jnp.einsum('bsd,de->bse', u, w_in)
    gate_b, gate_c, v = jnp.split(bcv, 3, axis=-1)
    z = gate_c * v
    zf = jnp.concatenate([hist.astype(z.dtype), z], axis=1)
    conv = sum(kernel[k] * zf[:, k:k + s] for k in range(CONV_W))
    y = jnp.einsum('bsd,de->bse', gate_b * conv, w_out)
    return y, zf[:, -(CONV_W - 1):]


def pool_mixer(u, hist, start_pos, w_group, scale):
    s = u.shape[1]
    full = jnp.concatenate([hist.astype(u.dtype), u], axis=1)
    ff = full.astype(jnp.float32)
    cs = jnp.concatenate([jnp.zeros_like(ff[:, :1]), jnp.cumsum(ff, axis=1)], axis=1)
    pos = start_pos + jnp.arange(s)
    uf = u.astype(jnp.float32)
    outs = []
    for g, w in enumerate(POOL_WINDOWS):
        sl = slice(g * POOL_GROUP, (g + 1) * POOL_GROUP)
        lo = POOL_HIST + 1
        win_sum = cs[:, lo:lo + s, sl] - cs[:, lo - w:lo - w + s, sl]
        count = jnp.minimum(pos + 1, w).astype(jnp.float32)[None, :, None]
        diff = win_sum / count - uf[:, :, sl]
        outs.append(jnp.einsum('bsc,cd->bsd', diff.astype(u.dtype), w_group[g]))
    y = jnp.concatenate(outs, axis=-1) * scale
    return y, full[:, -POOL_HIST:]


def trunk(x, conv_hist, pool_hist, start_pos, norm_gains, ffn_w_gate, ffn_w_up, ffn_w_down,
          conv_w_in, conv_kernel, conv_w_out, pool_w_group, pool_scale):
    new_conv, new_pool = [], []
    for i in range(DEPTH):
        g = norm_gains[i]
        h = rmsnorm(x, g[0])
        x = x + 0.5 * rmsnorm(swiglu(h, ffn_w_gate[i, 0], ffn_w_up[i, 0], ffn_w_down[i, 0]), g[1])
        h = rmsnorm(x, g[2])
        j = i // N_MIXERS
        if i % N_MIXERS == 0:
            m, nh = conv_mixer(h, conv_hist[j], conv_w_in[j], conv_kernel[j], conv_w_out[j])
            new_conv.append(nh)
        else:
            m, nh = pool_mixer(h, pool_hist[j], start_pos, pool_w_group[j], pool_scale[j])
            new_pool.append(nh)
        x = x + rmsnorm(m, g[3])
        h = rmsnorm(x, g[4])
        x = x + 0.5 * rmsnorm(swiglu(h, ffn_w_gate[i, 1], ffn_w_up[i, 1], ffn_w_down[i, 1]), g[5])
    return x, jnp.stack(new_conv), jnp.stack(new_pool)


def setup_inputs(seed: int = 0) -> dict:
    key = jax.random.key(seed)
    ks = jax.random.split(key, 14)
    f32 = jnp.float32
    nrm = lambda k, shape, sc: jax.random.normal(k, shape, f32) * sc
    return {
        "x_prompt": nrm(ks[0], (BATCH, SEQ, D_MODEL), 1.0),
        "x_sample": nrm(ks[1], (DEC_BATCH, DEC_SEQ, D_MODEL), 1.0),
        "state_conv": nrm(ks[2], (N_CONV, DEC_BATCH, CONV_W - 1, D_MODEL), 1.0),
        "state_pool": nrm(ks[3], (N_POOL, DEC_BATCH, POOL_HIST, D_MODEL), 1.0),
        "norm_gains": 1.0 + nrm(ks[4], (DEPTH, N_NORMS, D_MODEL), 0.1),
        "ffn_w_gate": nrm(ks[5], (DEPTH, 2, D_MODEL, D_FF), D_MODEL ** -0.5),
        "ffn_w_up": nrm(ks[6], (DEPTH, 2, D_MODEL, D_FF), D_MODEL ** -0.5),
        "ffn_w_down": nrm(ks[7], (DEPTH, 2, D_FF, D_MODEL), D_FF ** -0.5),
        "conv_w_in": nrm(ks[8], (N_CONV, D_MODEL, 3 * D_MODEL), D_MODEL ** -0.5),
        "conv_kernel": nrm(ks[9], (N_CONV, CONV_W, D_MODEL), CONV_W ** -0.5),
        "conv_w_out": nrm(ks[10], (N_CONV, D_MODEL, D_MODEL), D_MODEL ** -0.5),
        "pool_w_group": nrm(ks[11], (N_POOL, N_POOL_GROUPS, POOL_GROUP, POOL_GROUP), POOL_GROUP ** -0.5),
        "pool_scale": 1.0 + nrm(ks[12], (N_POOL, D_MODEL), 0.1),
    }


def reference(x_prompt, x_sample, state_conv, state_pool, norm_gains, ffn_w_gate, ffn_w_up,
              ffn_w_down, conv_w_in, conv_kernel, conv_w_out, pool_w_group, pool_scale):
    conv_hist_p = jnp.zeros((N_CONV, x_prompt.shape[0], CONV_W - 1, D_MODEL), x_prompt.dtype)
    pool_hist_p = jnp.zeros((N_POOL, x_prompt.shape[0], POOL_HIST, D_MODEL), x_prompt.dtype)
    y_prompt, new_conv_prompt, new_pool_prompt = trunk(
        x_prompt, conv_hist_p, pool_hist_p, 0, norm_gains, ffn_w_gate, ffn_w_up, ffn_w_down,
        conv_w_in, conv_kernel, conv_w_out, pool_w_group, pool_scale)
    y_sample, new_conv_sample, new_pool_sample = trunk(
        x_sample, state_conv, state_pool, PAST_LEN, norm_gains, ffn_w_gate, ffn_w_up, ffn_w_down,
        conv_w_in, conv_kernel, conv_w_out, pool_w_group, pool_scale)
    return (y_prompt, y_sample, new_conv_prompt, new_conv_sample, new_pool_prompt, new_pool_sample)
```

```cpp
#include <hip/hip_runtime.h>
#include <hip/hip_cooperative_groups.h>
#include <cstdio>
#include <cstdint>
namespace cg = cooperative_groups;

#define LAS __attribute__((address_space(3)))
typedef unsigned short bf16_t;
typedef short bf16x8 __attribute__((ext_vector_type(8)));
typedef float f32x4 __attribute__((ext_vector_type(4)));
typedef float f32x2 __attribute__((ext_vector_type(2)));
typedef unsigned u32x4 __attribute__((ext_vector_type(4)));
typedef unsigned u32x2 __attribute__((ext_vector_type(2)));

constexpr int D = 1024, FF = 2816, SEQ = 2048, NB = 8, MP = NB * SEQ, DB = 128, DS = 4, MS = DB * DS, M = MP + MS, NPAN = M / 256;
constexpr int DEPTH = 4;
constexpr float EPS = 1e-6f;
constexpr int NWAVES = 8, NTHREADS = 512;
constexpr int LDS_BYTES = 147456;

constexpr size_t O_Y = 0, O_NCP = (size_t)M * D, O_NCS = O_NCP + 2 * NB * 2 * D, O_NPP = O_NCS + 2 * DB * 2 * D, O_NPS = O_NPP + 2 * NB * 15 * D, O_END = O_NPS + (size_t)2 * DB * 15 * D;

constexpr size_t MiB = 1u << 20;
constexpr size_t WS_RSTD = 1 * MiB;
constexpr size_t WS_WGU = 2 * MiB, SZ_WGU = (size_t)2 * FF * D * 2;
constexpr size_t WS_WD = WS_WGU + 8 * SZ_WGU, SZ_WD = (size_t)D * FF * 2;
constexpr size_t WS_WIN = WS_WD + 8 * SZ_WD, SZ_WIN = (size_t)3 * D * D * 2;
constexpr size_t WS_WOUT = WS_WIN + 2 * SZ_WIN, SZ_WOUT = (size_t)D * D * 2;
constexpr size_t WS_WPOOL = WS_WOUT + 2 * SZ_WOUT, SZ_WPOOL = (size_t)4 * 256 * 256 * 2;
constexpr size_t WS_XB = 152 * MiB;
constexpr size_t WS_T = 186 * MiB;
constexpr size_t WS_Z = WS_T, WS_GB = WS_T + 33 * MiB, WS_U = WS_T + 66 * MiB;
constexpr size_t WS_F = 286 * MiB;
constexpr size_t WS_END = 352 * MiB;
static_assert(WS_WPOOL + 2 * SZ_WPOOL <= WS_XB && WS_XB + (size_t)M * D * 2 <= WS_T && WS_U + (size_t)M * D * 2 <= WS_F && WS_T + (size_t)M * FF * 2 <= WS_F && WS_F + (size_t)M * D * 4 <= WS_END, "ws map");

__device__ __forceinline__ unsigned cvt_pk_bf16(float lo, float hi) { unsigned r; asm volatile("v_cvt_pk_bf16_f32 %0, %1, %2" : "=v"(r) : "v"(lo), "v"(hi)); return r; }
__device__ __forceinline__ float bf_lo(unsigned w) { return __uint_as_float(w << 16); }
__device__ __forceinline__ float bf_hi(unsigned w) { return __uint_as_float(w & 0xffff0000u); }
__device__ __forceinline__ float wave_sum(float v) {
#pragma unroll
    for (int o = 1; o < 64; o <<= 1) v += __shfl_xor(v, o);
    return v;
}
__device__ __forceinline__ float silu_f(float g) { return g * __builtin_amdgcn_rcpf(1.0f + __builtin_amdgcn_exp2f(-1.4426950408889634f * g)); }

namespace pg8 {
constexpr int BM = 256, BK = 64, HALF = 128, HTB = HALF * BK * 2, STAGE_BYTES = 8 * HTB, NXCD = 8, WGM = 8;
__host__ __device__ __forceinline__ int lds_byte(int r, int c) { const int st = (r >> 4) * 2 + (c >> 5), rr = r & 15, cc = c & 31, ob = rr * 64 + cc * 2; return st * 1024 + (ob ^ (((ob >> 9) & 1) << 5)); }
__host__ __device__ __forceinline__ void stage_rc(int b, int& R, int& C) { const int st = b / 1024, sb = b % 1024, swz = sb ^ (((sb >> 9) & 1) << 5); R = (st >> 1) * 16 + swz / 64; C = (st & 1) * 32 + (swz % 64) / 2; }
__host__ __device__ __forceinline__ int perm32(int rho) { const int n = rho >> 4, i = rho & 15; return 8 * (i >> 2) + 4 * n + (i & 3); }

struct Unit { int pm, pn; };
struct Gemm { const bf16_t* A; int lda; int acol; const bf16_t* Bt; int K; int nM, nN; };

struct StaticOrder {
    int nM, nN, nwg, G, c;
    __device__ void init(int nM_, int nN_, int G_, int c_) { nM = nM_; nN = nN_; nwg = nM * nN; G = G_; c = c_; }
    __device__ bool next(int i, Unit& u) const {
        const long L = (long)i * G + c; if (L >= nwg) return false;
        int wgid = (int)L; { const int q = nwg / NXCD, r = nwg % NXCD, xcd = wgid % NXCD, off = wgid / NXCD; wgid = (xcd < r ? xcd * (q + 1) : r * (q + 1) + (xcd - r) * q) + off; }
        const int nig = WGM * nN, gid = wgid / nig, fm = gid * WGM, gsz = (nM - fm) < WGM ? (nM - fm) : WGM;
        u.pm = fm + ((wgid % nig) % gsz); u.pn = (wgid % nig) / gsz; return true;
    }
    __device__ __forceinline__ void a_ready(const Unit&) const {}
    __device__ __forceinline__ void done(const Unit&) const {}
};

struct EpiGU {
    static constexpr bool PERM = true;
    bf16_t* T; const float* rstd;
    __device__ __forceinline__ void operator()(const f32x4 (&acc)[2][2][4][2], const Unit& u, int wr, int wc, int fr, int fq) const {
        const int row0 = u.pm * BM + wr * 64 + fr; const int col0 = u.pn * HALF + wc * 32 + 8 * fq;
#pragma unroll
        for (int ai = 0; ai < 2; ++ai)
#pragma unroll
            for (int m = 0; m < 4; ++m) {
                const int r = row0 + ai * HALF + m * 16; const float rs = rstd[r];
                float o[8];
#pragma unroll
                for (int n = 0; n < 2; ++n)
#pragma unroll
                    for (int i = 0; i < 4; ++i) { const float g = acc[ai][0][m][n][i] * rs, v = acc[ai][1][m][n][i] * rs; o[n * 4 + i] = silu_f(g) * v; }
                u32x4 w; w.x = cvt_pk_bf16(o[0], o[1]); w.y = cvt_pk_bf16(o[2], o[3]); w.z = cvt_pk_bf16(o[4], o[5]); w.w = cvt_pk_bf16(o[6], o[7]);
                *(u32x4*)(T + (size_t)r * FF + col0) = w;
            }
    }
};
struct EpiF32 {
    static constexpr bool PERM = false;
    float* F; const float* scale;
    __device__ __forceinline__ void operator()(const f32x4 (&acc)[2][2][4][2], const Unit& u, int wr, int wc, int fr, int fq) const {
        const int row0 = u.pm * BM + wr * 64 + fr; const int col0 = u.pn * BM + wc * 32 + 4 * fq;
        f32x4 sv[2][2];
#pragma unroll
        for (int bj = 0; bj < 2; ++bj)
#pragma unroll
            for (int n = 0; n < 2; ++n) sv[bj][n] = scale ? *(const f32x4*)(scale + col0 + bj * HALF + n * 16) : (f32x4){1.f, 1.f, 1.f, 1.f};
#pragma unroll
        for (int ai = 0; ai < 2; ++ai)
#pragma unroll
            for (int m = 0; m < 4; ++m) { float* rowp = F + (size_t)(row0 + ai * HALF + m * 16) * D + col0;
#pragma unroll
                for (int bj = 0; bj < 2; ++bj)
#pragma unroll
                    for (int n = 0; n < 2; ++n) *(f32x4*)(rowp + bj * HALF + n * 16) = acc[ai][bj][m][n] * sv[bj][n]; }
    }
};
struct EpiCI {
    static constexpr bool PERM = true;
    bf16_t* Z; bf16_t* GB; const float* rstd; float* ncp; float* ncs;
    __device__ __forceinline__ void operator()(const f32x4 (&acc)[2][2][4][2], const Unit& u, int wr, int wc, int fr, int fq) const {
        const int row0 = u.pm * BM + wr * 64 + fr;
        if (u.pn < 8) {
            const int col0 = u.pn * HALF + wc * 32 + 8 * fq;
#pragma unroll
            for (int ai = 0; ai < 2; ++ai)
#pragma unroll
                for (int m = 0; m < 4; ++m) {
                    const int r = row0 + ai * HALF + m * 16; const float rs = rstd[r], rs2 = rs * rs;
                    f32x4 z0 = acc[ai][0][m][0] * acc[ai][1][m][0] * rs2, z1 = acc[ai][0][m][1] * acc[ai][1][m][1] * rs2;
                    u32x4 w; w.x = cvt_pk_bf16(z0[0], z0[1]); w.y = cvt_pk_bf16(z0[2], z0[3]); w.z = cvt_pk_bf16(z1[0], z1[1]); w.w = cvt_pk_bf16(z1[2], z1[3]);
                    *(u32x4*)(Z + (size_t)r * D + col0) = w;
                    float* dst = nullptr;
                    if (r < MP) { const int t = r & (SEQ - 1); if (t >= SEQ - 2) dst = ncp + ((size_t)(r >> 11) * 2 + (t - (SEQ - 2))) * D; }
                    else { const int s = r - MP, t = s & 3; if (t >= 2) dst = ncs + ((size_t)(s >> 2) * 2 + (t - 2)) * D; }
                    if (dst) { *(f32x4*)(dst + col0) = z0; *(f32x4*)(dst + col0 + 4) = z1; }
                }
        } else {
            const int col0 = (u.pn - 8) * BM + wc * 32 + 8 * fq;
#pragma unroll
            for (int ai = 0; ai < 2; ++ai)
#pragma unroll
                for (int m = 0; m < 4; ++m) {
                    const int r = row0 + ai * HALF + m * 16; const float rs = rstd[r];
#pragma unroll
                    for (int bj = 0; bj < 2; ++bj) { const f32x4 v0 = acc[ai][bj][m][0] * rs, v1 = acc[ai][bj][m][1] * rs;
                        u32x4 w; w.x = cvt_pk_bf16(v0[0], v0[1]); w.y = cvt_pk_bf16(v0[2], v0[3]); w.z = cvt_pk_bf16(v1[0], v1[1]); w.w = cvt_pk_bf16(v1[2], v1[3]);
                        *(u32x4*)(GB + (size_t)r * D + col0 + bj * HALF) = w; }
                }
        }
    }
};

template <class Epi, class Sched, bool ALIGN_EPI>
__device__ __forceinline__ void gemm_phase(LAS unsigned char* lds, const Gemm g, const Sched& S, const Epi& E) {
    int tid = threadIdx.x; asm volatile("" : "+v"(tid));
    const int wid = __builtin_amdgcn_readfirstlane(tid >> 6), lane = tid & 63, wr = wid >> 2, wc = wid & 3, fr = lane & 15, fq = lane >> 4;
    const int K = g.K, nt = K / BK, lda = g.lda;
    unsigned voffA[2], voffB[2];
#pragma unroll
    for (int i = 0; i < 2; ++i) { int R, C; stage_rc(tid * 16 + i * 8192, R, C); const int Rb = Epi::PERM ? ((R & ~31) + perm32(R & 31)) : R;
        voffA[i] = (unsigned)(R * lda + C) * 2u; voffB[i] = (unsigned)(Rb * K + C) * 2u; }
    const size_t kstep = (size_t)(BK * 2);
    const size_t hstepA = (size_t)HALF * lda * 2, hstepB = (size_t)HALF * K * 2;
    const size_t tstepA = 2 * hstepA, tstepB = 2 * hstepB;
    const size_t acolB = (size_t)g.acol * 2;
    const unsigned ldsw = (unsigned)wid * 1024u;
    const int aoff = lds_byte(wr * 64 + fr, fq * 8), boff = lds_byte(wc * 32 + fr, fq * 8);
#define PG8_SA(b, h) (((b) * 2 + (h)) * HTB)
#define PG8_SB(b, h) ((4 + (b) * 2 + (h)) * HTB)
#define PG8_STAGE(bufoff, gbase, voff) do { _Pragma("unroll") for (int _i = 0; _i < 2; ++_i) \
        __builtin_amdgcn_global_load_lds((const unsigned*)((const char*)(gbase) + (voff)[_i]), (LAS unsigned*)(lds + (bufoff) + ldsw + _i * 8192), 16, 0, 0); } while (0)
#define PG8_LDA(dst, b, h) do { _Pragma("unroll") for (int m = 0; m < 4; ++m) _Pragma("unroll") for (int k = 0; k < 2; ++k) dst[m][k] = *(const LAS bf16x8*)(lds + PG8_SA(b, h) + aoff + m * 2048 + k * 1024); } while (0)
#define PG8_LDB(dst, b, h) do { _Pragma("unroll") for (int n = 0; n < 2; ++n) _Pragma("unroll") for (int k = 0; k < 2; ++k) dst[n][k] = *(const LAS bf16x8*)(lds + PG8_SB(b, h) + boff + n * 2048 + k * 1024); } while (0)
#define PG8_MMA(ai, bj, At, Bt) do { __builtin_amdgcn_s_setprio(1); _Pragma("unroll") for (int m = 0; m < 4; ++m) _Pragma("unroll") for (int n = 0; n < 2; ++n) _Pragma("unroll") for (int k = 0; k < 2; ++k) \
        acc[ai][bj][m][n] = __builtin_amdgcn_mfma_f32_16x16x32_bf16(Bt[n][k], At[m][k], acc[ai][bj][m][n], 0, 0, 0); __builtin_amdgcn_s_setprio(0); } while (0)
#define PG8_WAIT_V(n) asm volatile("s_waitcnt vmcnt(" #n ")" ::: "memory")
#define PG8_WAIT_L(n) asm volatile("s_waitcnt lgkmcnt(" #n ")" ::: "memory")
#define PG8_BAR __builtin_amdgcn_s_barrier()
#define PG8_SCHED __builtin_amdgcn_sched_barrier(0)
    Unit cur, nxt; int ui = 0;
    if (!S.next(0, cur)) return;
    f32x4 acc[2][2][4][2];
#pragma unroll
    for (int a = 0; a < 2; ++a)
#pragma unroll
        for (int b = 0; b < 2; ++b)
#pragma unroll
            for (int m = 0; m < 4; ++m)
#pragma unroll
                for (int n = 0; n < 2; ++n) acc[a][b][m][n] = (f32x4){0.f, 0.f, 0.f, 0.f};
    bf16x8 At[4][2], B0[2][2], B1[2][2];
    const char* cA = (const char*)g.A + (size_t)cur.pm * tstepA + (size_t)cur.pn * acolB; const char* cB = (const char*)g.Bt + (size_t)cur.pn * tstepB;
    S.a_ready(cur);
    PG8_STAGE(PG8_SB(0, 0), cB, voffB); PG8_STAGE(PG8_SB(0, 1), cB + hstepB, voffB); PG8_STAGE(PG8_SA(0, 0), cA, voffA); PG8_STAGE(PG8_SA(0, 1), cA + hstepA, voffA);
    if (wr == 1) PG8_BAR;
    PG8_WAIT_V(2); PG8_BAR;
    PG8_STAGE(PG8_SB(1, 0), cB + kstep, voffB); PG8_STAGE(PG8_SA(1, 0), cA + kstep, voffA); PG8_STAGE(PG8_SB(1, 1), cB + hstepB + kstep, voffB);
    PG8_WAIT_V(6); PG8_BAR;
    for (;;) {
        const bool has_next = S.next(ui + 1, nxt);
        const char* nA = has_next ? (const char*)g.A + (size_t)nxt.pm * tstepA + (size_t)nxt.pn * acolB : cA; const char* nB = has_next ? (const char*)g.Bt + (size_t)nxt.pn * tstepB : cB;
        for (int t = 0; t < nt; t += 2) {
            const bool last = (t == nt - 2);
            const char* a1 = cA + (size_t)(t + 1) * kstep;
            const char* a2 = last ? nA : cA + (size_t)(t + 2) * kstep; const char* b2 = last ? nB : cB + (size_t)(t + 2) * kstep;
            const char* a3 = a2 + kstep; const char* b3 = b2 + kstep;
            if (last && has_next) S.a_ready(nxt);
            PG8_LDB(B0, 0, 0); PG8_LDB(B1, 0, 1); PG8_SCHED; PG8_LDA(At, 0, 0); PG8_STAGE(PG8_SA(1, 1), a1 + hstepA, voffA);
            PG8_WAIT_V(8); PG8_WAIT_L(0); PG8_BAR; PG8_MMA(0, 0, At, B0); PG8_MMA(0, 1, At, B1); PG8_BAR; PG8_SCHED;
            PG8_LDA(At, 0, 1); PG8_STAGE(PG8_SB(0, 0), b2, voffB); PG8_STAGE(PG8_SB(0, 1), b2 + hstepB, voffB); PG8_STAGE(PG8_SA(0, 0), a2, voffA);
            PG8_WAIT_V(8); PG8_WAIT_L(0); PG8_BAR; PG8_MMA(1, 0, At, B0); PG8_MMA(1, 1, At, B1); PG8_BAR; PG8_SCHED;
            PG8_LDB(B0, 1, 0); PG8_LDB(B1, 1, 1); PG8_SCHED; PG8_LDA(At, 1, 0); PG8_STAGE(PG8_SA(0, 1), a2 + hstepA, voffA);
            PG8_WAIT_V(8); PG8_WAIT_L(0); PG8_BAR; PG8_MMA(0, 0, At, B0); PG8_MMA(0, 1, At, B1); PG8_BAR; PG8_SCHED;
            PG8_LDA(At, 1, 1); PG8_STAGE(PG8_SB(1, 0), b3, voffB); PG8_STAGE(PG8_SB(1, 1), b3 + hstepB, voffB); PG8_STAGE(PG8_SA(1, 0), a3, voffA);
            PG8_WAIT_V(8); PG8_WAIT_L(0); PG8_BAR; PG8_MMA(1, 0, At, B0); PG8_MMA(1, 1, At, B1); PG8_BAR; PG8_SCHED;
        }
        if constexpr (ALIGN_EPI) { if (wr == 0) PG8_BAR; }
        E(acc, cur, wr, wc, fr, fq); S.done(cur);
        if (!has_next) break;
#pragma unroll
        for (int a = 0; a < 2; ++a)
#pragma unroll
            for (int b = 0; b < 2; ++b)
#pragma unroll
                for (int m = 0; m < 4; ++m)
#pragma unroll
                    for (int n = 0; n < 2; ++n) acc[a][b][m][n] = (f32x4){0.f, 0.f, 0.f, 0.f};
        cur = nxt; cA = nA; cB = nB; ++ui;
        if constexpr (ALIGN_EPI) { if (wr == 1) PG8_BAR; }
    }
    PG8_WAIT_V(0);
    if constexpr (!ALIGN_EPI) { if (wr == 0) PG8_BAR; }
    PG8_BAR;
#undef PG8_SA
#undef PG8_SB
#undef PG8_STAGE
#undef PG8_LDA
#undef PG8_LDB
#undef PG8_MMA
#undef PG8_WAIT_V
#undef PG8_WAIT_L
#undef PG8_BAR
#undef PG8_SCHED
}
}

struct Args {
    const float* in[13];
    float* out; unsigned char* ws;
};

__device__ __forceinline__ void transpose_item(const float* W, int src_ld, int k0, int n0, bf16_t* WT, int dst_ld, int dst_row0, const float* gain, LAS float* scr, int lane) {
#pragma unroll 8
    for (int i = 0; i < 32; ++i) { const int kk = 2 * i + (lane >> 5); float v = W[(size_t)(k0 + kk) * src_ld + n0 + (lane & 31)]; if (gain) v *= gain[k0 + kk]; scr[kk * 33 + (lane & 31)] = v; }
    asm volatile("s_waitcnt lgkmcnt(0)" ::: "memory");
    const int c = lane & 7;
#pragma unroll
    for (int j = 0; j < 4; ++j) { const int n = (lane >> 3) + 8 * j; const LAS float* s = scr + (8 * c) * 33 + n;
        u32x4 o; o.x = cvt_pk_bf16(s[0 * 33], s[1 * 33]); o.y = cvt_pk_bf16(s[2 * 33], s[3 * 33]); o.z = cvt_pk_bf16(s[4 * 33], s[5 * 33]); o.w = cvt_pk_bf16(s[6 * 33], s[7 * 33]);
        *(u32x4*)(WT + (size_t)(dst_row0 + n) * dst_ld + k0 + 8 * c) = o; }
    asm volatile("s_waitcnt lgkmcnt(0)" ::: "memory");
}

__device__ __forceinline__ void prologue(const Args& a, LAS unsigned char* lds, int gw, int NGW, int wave) {
    int lane = threadIdx.x & 63; asm volatile("" : "+v"(lane));
    LAS float* scr = (LAS float*)(lds + wave * 16384);
    unsigned char* ws = a.ws;
    const float* gains = a.in[4];
    constexpr int I_FFN = (D / 64) * (FF / 32);
    constexpr int I_CIN = (D / 64) * (3 * D / 32);
    constexpr int I_COUT = (D / 64) * (D / 32);
    constexpr int I_POOL = (256 / 64) * (256 / 32);
    constexpr int N_FFN = 8 * 3 * I_FFN, N_CIN = 2 * I_CIN, N_COUT = 2 * I_COUT, N_POOL = 8 * I_POOL;
    constexpr int NITEMS = N_FFN + N_CIN + N_COUT + N_POOL;
    for (int it = gw; it < NITEMS; it += NGW) {
        int r = it;
        if (r < N_FFN) {
            const int ls = r / (3 * I_FFN), q = r % (3 * I_FFN), which = q / I_FFN, item = q % I_FFN, l = ls >> 1, s = ls & 1;
            if (which < 2) {
                const int nblk = FF / 32, kb = item / nblk, nb = item % nblk, n0 = 32 * nb;
                const float* W = a.in[5 + which] + (size_t)ls * D * FF;
                const int drow = 256 * (n0 >> 7) + (n0 & 127) + which * 128;
                transpose_item(W, FF, 64 * kb, n0, (bf16_t*)(ws + WS_WGU + ls * SZ_WGU), D, drow, gains + (size_t)(l * 6 + (s ? 4 : 0)) * D, scr, lane);
            } else {
                const int nblk = D / 32, kb = item / nblk, nb = item % nblk, n0 = 32 * nb;
                const float* W = a.in[7] + (size_t)ls * FF * D;
                transpose_item(W, D, 64 * kb, n0, (bf16_t*)(ws + WS_WD + ls * SZ_WD), FF, n0, nullptr, scr, lane);
            }
            continue;
        }
        r -= N_FFN;
        if (r < N_CIN) {
            const int j = r / I_CIN, item = r % I_CIN, nblk = 3 * D / 32, kb = item / nblk, nb = item % nblk, n0 = 32 * nb;
            int drow;
            if (n0 < D) drow = 2048 + n0;
            else if (n0 < 2 * D) { const int c = n0 - D; drow = 256 * (c >> 7) + (c & 127); }
            else { const int c = n0 - 2 * D; drow = 256 * (c >> 7) + 128 + (c & 127); }
            transpose_item(a.in[8] + (size_t)j * D * 3 * D, 3 * D, 64 * kb, n0, (bf16_t*)(ws + WS_WIN + j * SZ_WIN), D, drow, gains + (size_t)((2 * j) * 6 + 2) * D, scr, lane);
            continue;
        }
        r -= N_CIN;
        if (r < N_COUT) {
            const int j = r / I_COUT, item = r % I_COUT, nblk = D / 32, kb = item / nblk, nb = item % nblk, n0 = 32 * nb;
            transpose_item(a.in[10] + (size_t)j * D * D, D, 64 * kb, n0, (bf16_t*)(ws + WS_WOUT + j * SZ_WOUT), D, n0, nullptr, scr, lane);
            continue;
        }
        r -= N_COUT;
        {
            const int jg = r / I_POOL, item = r % I_POOL, nblk = 256 / 32, kb = item / nblk, nb = item % nblk, n0 = 32 * nb;
            transpose_item(a.in[11] + (size_t)jg * 65536, 256, 64 * kb, n0, (bf16_t*)(ws + WS_WPOOL) + (size_t)jg * 65536, 256, n0, nullptr, scr, lane);
        }
    }
    float* X = a.out + O_Y; bf16_t* XB = (bf16_t*)(ws + WS_XB); float* RS = (float*)(ws + WS_RSTD);
    for (int r = gw; r < M; r += NGW) {
        const float* src = r < MP ? a.in[0] + (size_t)r * D : a.in[1] + (size_t)(r - MP) * D;
        const f32x4* xr = (const f32x4*)src + lane; f32x4 v[4]; float s = 0.f;
#pragma unroll
        for (int j = 0; j < 4; ++j) { v[j] = xr[64 * j]; s += (v[j].x * v[j].x + v[j].y * v[j].y) + (v[j].z * v[j].z + v[j].w * v[j].w); }
        s = wave_sum(s);
        if (lane == 0) RS[r] = 1.0f / sqrtf(s * (1.0f / D) + EPS);
        f32x4* xo = (f32x4*)(X + (size_t)r * D) + lane; u32x2* bo = (u32x2*)(XB + (size_t)r * D) + lane;
#pragma unroll
        for (int j = 0; j < 4; ++j) { xo[64 * j] = v[j]; u32x2 w; w.x = cvt_pk_bf16(v[j].x, v[j].y); w.y = cvt_pk_bf16(v[j].z, v[j].w); bo[64 * j] = w; }
    }
}

__device__ __forceinline__ void e_phase(const Args& a, int gidx, float coef, int gw, int NGW) {
    int lane = threadIdx.x & 63; asm volatile("" : "+v"(lane));
    gidx = __builtin_amdgcn_readfirstlane(gidx); asm volatile("" : "+s"(gidx));
    const float* gain = a.in[4] + (size_t)gidx * D;
    float* X = a.out + O_Y; bf16_t* XB = (bf16_t*)(a.ws + WS_XB); float* RS = (float*)(a.ws + WS_RSTD); const float* F = (const float*)(a.ws + WS_F);
    f32x4 gv[4];
#pragma unroll
    for (int j = 0; j < 4; ++j) gv[j] = ((const f32x4*)gain)[lane + 64 * j];
    for (int r = gw; r < M; r += NGW) {
        const f32x4* fr_ = (const f32x4*)(F + (size_t)r * D) + lane; f32x4* xr = (f32x4*)(X + (size_t)r * D) + lane;
        f32x4 f[4], x[4]; float s = 0.f;
#pragma unroll
        for (int j = 0; j < 4; ++j) { f[j] = fr_[64 * j]; x[j] = xr[64 * j]; s += (f[j].x * f[j].x + f[j].y * f[j].y) + (f[j].z * f[j].z + f[j].w * f[j].w); }
        s = wave_sum(s);
        const float k = coef / sqrtf(s * (1.0f / D) + EPS); float s2 = 0.f;
#pragma unroll
        for (int j = 0; j < 4; ++j) { x[j] = x[j] + f[j] * gv[j] * k; s2 += (x[j].x * x[j].x + x[j].y * x[j].y) + (x[j].z * x[j].z + x[j].w * x[j].w); }
        s2 = wave_sum(s2);
        if (lane == 0) RS[r] = 1.0f / sqrtf(s2 * (1.0f / D) + EPS);
        u32x2* bo = (u32x2*)(XB + (size_t)r * D) + lane;
#pragma unroll
        for (int j = 0; j < 4; ++j) { xr[64 * j] = x[j]; u32x2 w; w.x = cvt_pk_bf16(x[j].x, x[j].y); w.y = cvt_pk_bf16(x[j].z, x[j].w); bo[64 * j] = w; }
    }
}

__device__ __forceinline__ void ce_phase(const Args& a, int j, int gw, int NGW) {
    int lane = threadIdx.x & 63; asm volatile("" : "+v"(lane));
    const bf16_t* Z = (const bf16_t*)(a.ws + WS_Z); const bf16_t* GB = (const bf16_t*)(a.ws + WS_GB); bf16_t* U = (bf16_t*)(a.ws + WS_U);
    const float* ker = a.in[9] + (size_t)j * 3 * D; const float* hist = a.in[2] + (size_t)j * DB * 2 * D;
    for (int r = gw; r < M; r += NGW) {
        int t; const float* h0 = nullptr;
        if (r < MP) t = r & (SEQ - 1); else { const int s = r - MP; t = s & 3; h0 = hist + (size_t)(s >> 2) * 2 * D; }
#pragma unroll
        for (int hh = 0; hh < 2; ++hh) {
            const int c = 8 * lane + 512 * hh;
            const u32x4 zc = *(const u32x4*)(Z + (size_t)r * D + c), gb = *(const u32x4*)(GB + (size_t)r * D + c);
            float z1[8], z2[8];
            if (t >= 1) { const u32x4 w = *(const u32x4*)(Z + (size_t)(r - 1) * D + c); z1[0] = bf_lo(w.x); z1[1] = bf_hi(w.x); z1[2] = bf_lo(w.y); z1[3] = bf_hi(w.y); z1[4] = bf_lo(w.z); z1[5] = bf_hi(w.z); z1[6] = bf_lo(w.w); z1[7] = bf_hi(w.w); }
            else if (h0) { const f32x4 p = *(const f32x4*)(h0 + D + c), q = *(const f32x4*)(h0 + D + c + 4); z1[0] = p.x; z1[1] = p.y; z1[2] = p.z; z1[3] = p.w; z1[4] = q.x; z1[5] = q.y; z1[6] = q.z; z1[7] = q.w; }
            else {
#pragma unroll
                for (int i = 0; i < 8; ++i) z1[i] = 0.f; }
            if (t >= 2) { const u32x4 w = *(const u32x4*)(Z + (size_t)(r - 2) * D + c); z2[0] = bf_lo(w.x); z2[1] = bf_hi(w.x); z2[2] = bf_lo(w.y); z2[3] = bf_hi(w.y); z2[4] = bf_lo(w.z); z2[5] = bf_hi(w.z); z2[6] = bf_lo(w.w); z2[7] = bf_hi(w.w); }
            else if (h0) { const float* hp = h0 + (size_t)t * D + c; const f32x4 p = *(const f32x4*)(hp), q = *(const f32x4*)(hp + 4); z2[0] = p.x; z2[1] = p.y; z2[2] = p.z; z2[3] = p.w; z2[4] = q.x; z2[5] = q.y; z2[6] = q.z; z2[7] = q.w; }
            else {
#pragma unroll
                for (int i = 0; i < 8; ++i) z2[i] = 0.f; }
            float z0[8] = {bf_lo(zc.x), bf_hi(zc.x), bf_lo(zc.y), bf_hi(zc.y), bf_lo(zc.z), bf_hi(zc.z), bf_lo(zc.w), bf_hi(zc.w)};
            float g8[8] = {bf_lo(gb.x), bf_hi(gb.x), bf_lo(gb.y), bf_hi(gb.y), bf_lo(gb.z), bf_hi(gb.z), bf_lo(gb.w), bf_hi(gb.w)};
            float o[8];
#pragma unroll
            for (int q = 0; q < 2; ++q) { const f32x4 k0 = *(const f32x4*)(ker + c + 4 * q), k1 = *(const f32x4*)(ker + D + c + 4 * q), k2 = *(const f32x4*)(ker + 2 * D + c + 4 * q);
#pragma unroll
                for (int i = 0; i < 4; ++i) o[4 * q + i] = g8[4 * q + i] * (k0[i] * z2[4 * q + i] + k1[i] * z1[4 * q + i] + k2[i] * z0[4 * q + i]); }
            u32x4 w; w.x = cvt_pk_bf16(o[0], o[1]); w.y = cvt_pk_bf16(o[2], o[3]); w.z = cvt_pk_bf16(o[4], o[5]); w.w = cvt_pk_bf16(o[6], o[7]);
            *(u32x4*)(U + (size_t)r * D + c) = w;
        }
    }
}

__device__ __forceinline__ void pe_phase(const Args& a, int l, int j, int bid, int G) {
    int tid = threadIdx.x; asm volatile("" : "+v"(tid));
    const float* X = a.out + O_Y; const float* RS = (const float*)(a.ws + WS_RSTD); bf16_t* DIFF = (bf16_t*)(a.ws + WS_Z);
    const int c = 2 * tid, w = 2 << (tid >> 7);
    const f32x2 gv = *(const f32x2*)(a.in[4] + (size_t)(l * 6 + 2) * D + c);
    const float inv_w = 1.0f / (float)w;
    for (int u = bid; u < 264; u += G) {
        if (u < 256) {
            const int b = u >> 5, t0 = (u & 31) * 64; const size_t rb = (size_t)b * SEQ;
            f32x2 S = {0.f, 0.f};
            for (int tt = t0 - w + 1; tt < t0; ++tt) if (tt >= 0) { const f32x2 xv = *(const f32x2*)(X + (rb + tt) * D + c); S += xv * gv * RS[rb + tt]; }
            float* npp = a.out + O_NPP + ((size_t)(j * NB + b) * 15) * D;
            for (int t = t0; t < t0 + 64; ++t) {
                const f32x2 hv = *(const f32x2*)(X + (rb + t) * D + c) * gv * RS[rb + t];
                S += hv;
                const float ic = (t + 1 < w) ? 1.0f / (float)(t + 1) : inv_w;
                const f32x2 df = S * ic - hv;
                *(unsigned*)(DIFF + (rb + t) * D + c) = cvt_pk_bf16(df.x, df.y);
                const int tb = t - w + 1;
                if (tb >= 0) { const f32x2 xv = *(const f32x2*)(X + (rb + tb) * D + c); S -= xv * gv * RS[rb + tb]; }
                if (t >= SEQ - 15) *(f32x2*)(npp + (size_t)(t - (SEQ - 15)) * D + c) = hv;
            }
        } else {
            const int u2 = u - 256;
            for (int i = 0; i < 16; ++i) {
                const int b = u2 * 16 + i; const size_t r0 = (size_t)MP + (size_t)b * 4;
                const float* hist = a.in[3] + ((size_t)(j * DB + b) * 15) * D + c;
                f32x2 full[19];
#pragma unroll
                for (int k = 0; k < 15; ++k) full[k] = *(const f32x2*)(hist + (size_t)k * D);
#pragma unroll
                for (int k = 0; k < 4; ++k) full[15 + k] = *(const f32x2*)(X + (r0 + k) * D + c) * gv * RS[r0 + k];
#pragma unroll
                for (int t = 0; t < 4; ++t) {
                    f32x2 S = {0.f, 0.f};
#pragma unroll
                    for (int q = 0; q < 16; ++q) if (q < w) S += full[15 + t - q];
                    const f32x2 df = S * inv_w - full[15 + t];
                    *(unsigned*)(DIFF + (r0 + t) * D + c) = cvt_pk_bf16(df.x, df.y);
                }
                float* nps = a.out + O_NPS + ((size_t)(j * DB + b) * 15) * D + c;
#pragma unroll
                for (int k = 0; k < 15; ++k) *(f32x2*)(nps + (size_t)k * D) = full[4 + k];
            }
        }
    }
}

__global__ void __launch_bounds__(NTHREADS, 2) fwd_kernel(Args args) {
    extern __shared__ __attribute__((aligned(16))) unsigned char lds_raw[];
    LAS unsigned char* lds = (LAS unsigned char*)lds_raw;
    cg::grid_group grid = cg::this_grid();
    const int wave = __builtin_amdgcn_readfirstlane(threadIdx.x >> 6);
    const int G = gridDim.x, bid = blockIdx.x, gw = bid * NWAVES + wave, NGW = G * NWAVES;
    unsigned char* ws = args.ws;
    bf16_t* XB = (bf16_t*)(ws + WS_XB); bf16_t* T = (bf16_t*)(ws + WS_T); float* F = (float*)(ws + WS_F); float* RS = (float*)(ws + WS_RSTD);

    prologue(args, lds, gw, NGW, wave);
    grid.sync();

    for (int l = 0; l < DEPTH; ++l) {
        const int j = l >> 1;
        for (int s = 0; s < 2; ++s) {
            if (s == 1) {
                if ((l & 1) == 0) {
                    { pg8::Gemm g{XB, D, 0, (const bf16_t*)(ws + WS_WIN + j * SZ_WIN), D, NPAN, 12}; pg8::StaticOrder S; S.init(NPAN, 12, G, bid);
                      pg8::EpiCI E{(bf16_t*)(ws + WS_Z), (bf16_t*)(ws + WS_GB), RS, args.out + O_NCP + (size_t)j * NB * 2 * D, args.out + O_NCS + (size_t)j * DB * 2 * D};
                      pg8::gemm_phase<pg8::EpiCI, pg8::StaticOrder, true>(lds, g, S, E); }
                    grid.sync();
                    ce_phase(args, j, gw, NGW);
                    grid.sync();
                    { pg8::Gemm g{(const bf16_t*)(ws + WS_U), D, 0, (const bf16_t*)(ws + WS_WOUT + j * SZ_WOUT), D, NPAN, 4}; pg8::StaticOrder S; S.init(NPAN, 4, G, bid);
                      pg8::EpiF32 E{F, nullptr};
                      pg8::gemm_phase<pg8::EpiF32, pg8::StaticOrder, true>(lds, g, S, E); }
                    grid.sync();
                } else {
                    pe_phase(args, l, j, bid, G);
                    grid.sync();
                    { pg8::Gemm g{(const bf16_t*)(ws + WS_Z), D, 256, (const bf16_t*)(ws + WS_WPOOL + j * SZ_WPOOL), 256, NPAN, 4}; pg8::StaticOrder S; S.init(NPAN, 4, G, bid);
                      pg8::EpiF32 E{F, args.in[12] + (size_t)j * D};
                      pg8::gemm_phase<pg8::EpiF32, pg8::StaticOrder, true>(lds, g, S, E); }
                    grid.sync();
                }
                e_phase(args, l * 6 + 3, 1.0f, gw, NGW);
                grid.sync();
            }
            const int ls = l * 2 + s;
            { pg8::Gemm g{XB, D, 0, (const bf16_t*)(ws + WS_WGU + ls * SZ_WGU), D, NPAN, 22}; pg8::StaticOrder S; S.init(NPAN, 22, G, bid);
              pg8::EpiGU E{T, RS};
              pg8::gemm_phase<pg8::EpiGU, pg8::StaticOrder, true>(lds, g, S, E); }
            grid.sync();
            { pg8::Gemm g{T, FF, 0, (const bf16_t*)(ws + WS_WD + ls * SZ_WD), FF, NPAN, 4}; pg8::StaticOrder S; S.init(NPAN, 4, G, bid);
              pg8::EpiF32 E{F, nullptr};
              pg8::gemm_phase<pg8::EpiF32, pg8::StaticOrder, true>(lds, g, S, E); }
            grid.sync();
            e_phase(args, l * 6 + (s ? 5 : 1), 0.5f, gw, NGW);
            if (!(l == DEPTH - 1 && s == 1)) grid.sync();
        }
    }
}

extern "C" void kernel_launch(void* const* d_in, const int* in_sizes, int n_in, void* d_out, int out_size, void* d_ws, size_t ws_size, hipStream_t stream) {
    static int grid = 0;
    if (grid == 0) {
        if (n_in != 13 || (size_t)out_size != O_END || ws_size < WS_END) { fprintf(stderr, "kernel_launch: unexpected shapes: n_in %d out %d ws %zu (need %zu)\n", n_in, out_size, ws_size, (size_t)WS_END); grid = -1; return; }
        int dev = 0, cus = 0, per_cu = 0;
        (void)hipGetDevice(&dev); (void)hipDeviceGetAttribute(&cus, hipDeviceAttributeMultiprocessorCount, dev);
        if (hipFuncSetAttribute((const void*)fwd_kernel, hipFuncAttributeMaxDynamicSharedMemorySize, LDS_BYTES) != hipSuccess) { fprintf(stderr, "kernel_launch: hipFuncSetAttribute failed\n"); grid = -1; return; }
        if (hipOccupancyMaxActiveBlocksPerMultiprocessor(&per_cu, (const void*)fwd_kernel, NTHREADS, LDS_BYTES) != hipSuccess || per_cu < 1) { fprintf(stderr, "kernel_launch: occupancy query says %d\n", per_cu); per_cu = 1; }
        (void)hipGetLastError();
        grid = cus;
        fprintf(stderr, "kernel_launch: grid %d (cus %d, per_cu %d)\n", grid, cus, per_cu);
    }
    if (grid < 0) return;
    Args a{};
    for (int i = 0; i < 13; ++i) a.in[i] = (const float*)d_in[i];
    a.out = (float*)d_out; a.ws = (unsigned char*)d_ws;
    void* kargs[] = {&a};
    hipError_t e = hipLaunchCooperativeKernel((const void*)fwd_kernel, dim3(grid), dim3(NTHREADS), kargs, LDS_BYTES, stream);
    if (e != hipSuccess) fprintf(stderr, "kernel_launch: cooperative launch failed: %s (grid %d)\n", hipGetErrorString(e), grid);
}
```
